# Optimizing an MI355X kernel written in HIP

```python
import math
import jax, jax.numpy as jnp
from jax import lax
import numpy as np

D_MODEL = 1024
BATCH = 2
SEQ = 8192
DEPTH = 2
DEC_BATCH = 128
DEC_SEQ = 1
PAST_LEN = 8192
PAGE_SIZE = 128

N_HEADS = 16
N_KV_HEADS = 4
GROUP = N_HEADS // N_KV_HEADS
HEAD_DIM = D_MODEL // N_HEADS
Q_W = N_HEADS * HEAD_DIM
KV_W = N_KV_HEADS * HEAD_DIM
WINDOW = 128
BLOCK = 128
N_BUCKETS = 32
MAX_DISTANCE = 128
D_CONV = D_MODEL
CONV_W = 3
D_FF = 2816
RMS_EPS = 1e-6
NEG = -1e30
W_BUF = min(WINDOW, PAST_LEN)
IN_W = 3 * D_CONV + Q_W + 2 * KV_W + 2 * D_MODEL
IN_SPLITS = (D_CONV, 2 * D_CONV, 3 * D_CONV, 3 * D_CONV + Q_W, 3 * D_CONV + Q_W + KV_W, 3 * D_CONV + Q_W + 2 * KV_W, 3 * D_CONV + Q_W + 2 * KV_W + D_MODEL)

kernel_name = "hybrid_conv_swa_sink_macaron_step"


def rmsnorm(x, g):
    xf = x.astype(jnp.float32)
    r = lax.rsqrt(jnp.mean(xf * xf, axis=-1, keepdims=True) + RMS_EPS)
    return (xf * r).astype(x.dtype) * g


def swiglu(h, w_gu, w_down):
    gate, up = jnp.split(h @ w_gu, 2, axis=-1)
    return (jax.nn.silu(gate) * up) @ w_down


def t5_bucket(rel):
    n = jnp.maximum(rel, 0)
    max_exact = N_BUCKETS // 2
    nf = jnp.maximum(n, 1).astype(jnp.float32)
    large = max_exact + (jnp.log(nf / max_exact) / math.log(MAX_DISTANCE / max_exact) * (N_BUCKETS - max_exact)).astype(jnp.int32)
    large = jnp.minimum(large, N_BUCKETS - 1)
    return jnp.where(n < max_exact, n, large)


def rel_bias_logits(rel, rel_bias):
    b = rel_bias.astype(jnp.float32)[t5_bucket(rel)]
    return jnp.moveaxis(b, -1, 0).reshape(N_KV_HEADS, GROUP, *rel.shape)


def sink_attend(q, k, v, bias, mask, sinks):
    s = jnp.einsum('...qhgd,...khd->...hgqk', q.astype(jnp.float32), k.astype(jnp.float32)) * (HEAD_DIM ** -0.5) + bias
    s = jnp.where(mask, s, NEG)
    sink = sinks.astype(jnp.float32).reshape(N_KV_HEADS, GROUP, 1, 1)
    m = jnp.maximum(jnp.max(s, axis=-1, keepdims=True), sink)
    p = jnp.exp(s - m)
    denom = jnp.sum(p, axis=-1, keepdims=True) + jnp.exp(sink - m)
    o = jnp.einsum('...hgqk,...khd->...qhgd', p / denom, v.astype(jnp.float32))
    return o.astype(v.dtype)


def banded_window_attention(q, k, v, sinks, rel_bias):
    b_, s_ = q.shape[0], q.shape[1]
    nb = s_ // BLOCK
    qb = q.reshape(b_, nb, BLOCK, N_KV_HEADS, GROUP, HEAD_DIM)

    def band(t):
        tb = t.reshape(b_, nb, BLOCK, N_KV_HEADS, HEAD_DIM)
        prev = jnp.concatenate([jnp.zeros_like(tb[:, :1]), tb[:, :-1]], axis=1)
        return jnp.concatenate([prev, tb], axis=2)

    qi = jnp.arange(BLOCK, dtype=jnp.int32)
    kj = jnp.arange(2 * BLOCK, dtype=jnp.int32)
    rel = qi[:, None] + BLOCK - kj[None, :]
    bias = rel_bias_logits(rel, rel_bias)
    key_abs = jnp.arange(nb, dtype=jnp.int32)[:, None] * BLOCK - BLOCK + kj[None, :]
    mask = ((rel >= 0) & (rel < WINDOW))[None] & (key_abs >= 0)[:, None, :]
    o = sink_attend(qb, band(k), band(v), bias, mask[:, None, None], sinks)
    w = min(WINDOW, s_)
    return o.reshape(b_, s_, N_KV_HEADS, GROUP, HEAD_DIM), k[:, -w:], v[:, -w:]


def decode_window_attention(q, k, v, k_buf, v_buf, sinks, rel_bias):
    t_ = q.shape[1]
    wb = k_buf.shape[1]
    kc = jnp.concatenate([k_buf.astype(k.dtype), k], axis=1)
    vc = jnp.concatenate([v_buf.astype(v.dtype), v], axis=1)
    qpos = PAST_LEN + jnp.arange(t_, dtype=jnp.int32)
    kpos = jnp.concatenate([PAST_LEN - wb + jnp.arange(wb, dtype=jnp.int32), qpos])
    rel = qpos[:, None] - kpos[None, :]
    bias = rel_bias_logits(rel, rel_bias)
    mask = (rel >= 0) & (rel < WINDOW)
    o = sink_attend(q, kc, vc, bias, mask, sinks)
    return o, kc[:, -wb:], vc[:, -wb:]


def token_mixer(h, conv_state, k_buf, v_buf, w_in, conv_w, w_conv_out, w_attn_out, w_out, sinks, rel_bias):
    prompt = conv_state is None
    nb_, t_ = h.shape[0], h.shape[1]
    cb, cc, cx, q, k, v, ga, gb = jnp.split(h @ w_in, IN_SPLITS, axis=-1)
    u = cc * cx
    if prompt:
        upad = jnp.concatenate([jnp.zeros((nb_, CONV_W - 1, D_CONV), u.dtype), u], axis=1)
    else:
        upad = jnp.concatenate([conv_state.astype(u.dtype), u], axis=1)
    yc = conv_w[0] * upad[:, 0:t_]
    for i in range(1, CONV_W):
        yc = yc + conv_w[i] * upad[:, i:i + t_]
    a_out = (cb * yc) @ w_conv_out
    new_conv = upad[:, -(CONV_W - 1):]
    q = q.reshape(nb_, t_, N_KV_HEADS, GROUP, HEAD_DIM)
    k = k.reshape(nb_, t_, N_KV_HEADS, HEAD_DIM)
    v = v.reshape(nb_, t_, N_KV_HEADS, HEAD_DIM)
    if prompt:
        o, new_k, new_v = banded_window_attention(q, k, v, sinks, rel_bias)
    else:
        o, new_k, new_v = decode_window_attention(q, k, v, k_buf, v_buf, sinks, rel_bias)
    att = o.reshape(nb_, t_, Q_W) @ w_attn_out
    merged = jax.nn.sigmoid(ga) * a_out + jax.nn.sigmoid(gb) * att
    return merged @ w_out, new_conv, new_k, new_v


def decoder_layer(x, conv_state, k_buf, v_buf, g, w_ff1_gu, w_ff1_down, w_in, conv_w, sinks, w_conv_out, w_attn_out, w_out, w_ff2_gu, w_ff2_down, rel_bias):
    x = x + 0.5 * rmsnorm(swiglu(rmsnorm(x, g[0]), w_ff1_gu, w_ff1_down), g[1])
    m, new_conv, new_k, new_v = token_mixer(rmsnorm(x, g[2]), conv_state, k_buf, v_buf, w_in, conv_w, w_conv_out, w_attn_out, w_out, sinks, rel_bias)
    x = x + rmsnorm(m, g[3])
    x = x + 0.5 * rmsnorm(swiglu(rmsnorm(x, g[4]), w_ff2_gu, w_ff2_down), g[5])
    return x, new_conv, new_k, new_v


def setup_inputs(seed: int = 0) -> dict:
    key = jax.random.key(seed)
    ks = jax.random.split(key, 20)
    f32 = jnp.float32
    nrm = lambda k, shape, scale: jax.random.normal(k, shape, f32) * scale
    return {
        "x_prompt": nrm(ks[0], (BATCH, SEQ, D_MODEL), 1.0),
        "x_sample": nrm(ks[1], (DEC_BATCH, DEC_SEQ, D_MODEL), 1.0),
        "state_conv": nrm(ks[2], (DEPTH, DEC_BATCH, CONV_W - 1, D_CONV), 1.0),
        "cache_k_win": nrm(ks[3], (DEPTH, DEC_BATCH, W_BUF, N_KV_HEADS, HEAD_DIM), 1.0),
        "cache_v_win": nrm(ks[4], (DEPTH, DEC_BATCH, W_BUF, N_KV_HEADS, HEAD_DIM), 1.0),
        "rel_bias": nrm(ks[5], (N_BUCKETS, N_HEADS), 0.5),
        "norm_g": 1.0 + nrm(ks[6], (DEPTH, 6, D_MODEL), 0.05),
        "w_ff1_gu": nrm(ks[7], (DEPTH, D_MODEL, 2 * D_FF), D_MODEL ** -0.5),
        "w_ff1_down": nrm(ks[8], (DEPTH, D_FF, D_MODEL), D_FF ** -0.5),
        "w_in": nrm(ks[9], (DEPTH, D_MODEL, IN_W), D_MODEL ** -0.5),
        "conv_w": nrm(ks[10], (DEPTH, CONV_W, D_CONV), CONV_W ** -0.5),
        "sinks": nrm(ks[11], (DEPTH, N_HEADS), 0.5),
        "w_conv_out": nrm(ks[12], (DEPTH, D_CONV, D_MODEL), D_CONV ** -0.5),
        "w_attn_out": nrm(ks[13], (DEPTH, Q_W, D_MODEL), Q_W ** -0.5),
        "w_out": nrm(ks[14], (DEPTH, D_MODEL, D_MODEL), D_MODEL ** -0.5),
        "w_ff2_gu": nrm(ks[15], (DEPTH, D_MODEL, 2 * D_FF), D_MODEL ** -0.5),
        "w_ff2_down": nrm(ks[16], (DEPTH, D_FF, D_MODEL), D_FF ** -0.5),
    }


def reference(x_prompt, x_sample, state_conv, cache_k_win, cache_v_win, rel_bias, norm_g, w_ff1_gu, w_ff1_down, w_in, conv_w, sinks, w_conv_out, w_attn_out, w_out, w_ff2_gu, w_ff2_down):
    yp, ys = x_prompt, x_sample
    pc, pk, pv, sc, sk, sv = [], [], [], [], [], []
    for l in range(DEPTH):
        yp, c1, k1, v1 = decoder_layer(yp, None, None, None, norm_g[l], w_ff1_gu[l], w_ff1_down[l], w_in[l], conv_w[l], sinks[l], w_conv_out[l], w_attn_out[l], w_out[l], w_ff2_gu[l], w_ff2_down[l], rel_bias)
        ys, c2, k2, v2 = decoder_layer(ys, state_conv[l], cache_k_win[l], cache_v_win[l], norm_g[l], w_ff1_gu[l], w_ff1_down[l], w_in[l], conv_w[l], sinks[l], w_conv_out[l], w_attn_out[l], w_out[l], w_ff2_gu[l], w_ff2_down[l], rel_bias)
        pc.append(c1); pk.append(k1); pv.append(v1)
        sc.append(c2); sk.append(k2); sv.append(v2)
    return (yp, ys, jnp.stack(pc), jnp.stack(pk), jnp.stack(pv), jnp.stack(sc), jnp.stack(sk), jnp.stack(sv))
```

```cpp
#include <hip/hip_runtime.h>
#include <cstdio>
#include <cstdint>

#ifndef MK_LAUNCH_PER_PHASE
#define MK_LAUNCH_PER_PHASE 1
#endif

constexpr int DM = 1024, SEQ = 8192, NBATCH = 2, MP = NBATCH * SEQ, MS = 128, MT = MP + MS;
constexpr int DFF = 2816, NGU = 2 * DFF, NIN = 6656, NKV = 256, NLAYER = 2;
constexpr float RMS_EPS = 1e-6f;
constexpr float LOG2E = 1.4426950408889634f;
constexpr float QSCALE = 0.125f * LOG2E;

__device__ __forceinline__ int opq_lane() { int l = __builtin_amdgcn_mbcnt_hi(~0u, __builtin_amdgcn_mbcnt_lo(~0u, 0u)); asm volatile("" : "+v"(l)); return l; }
__device__ __forceinline__ int opq_bid() { int b = blockIdx.x; asm volatile("" : "+s"(b)); return b; }
#define opq_tid() (wave_s * 64 + opq_lane())

namespace pg8 {
#define PG8_LAS __attribute__((address_space(3)))
typedef unsigned short bf16_t;
typedef short bf16x8 __attribute__((ext_vector_type(8)));
typedef float f32x4 __attribute__((ext_vector_type(4)));
typedef unsigned u32x4 __attribute__((ext_vector_type(4)));
constexpr int BM = 256, BK = 64, HALF = 128, HTB = HALF * BK * 2  , STAGE_BYTES = 8 * HTB, NXCD = 8, WGM = 8;

__host__ __device__ __forceinline__ int lds_byte(int r, int c) { const int st = (r >> 4) * 2 + (c >> 5), rr = r & 15, cc = c & 31, ob = rr * 64 + cc * 2; return st * 1024 + (ob ^ (((ob >> 9) & 1) << 5)); }
__host__ __device__ __forceinline__ void stage_rc(int b, int& R, int& C) { const int st = b / 1024, sb = b % 1024, swz = sb ^ (((sb >> 9) & 1) << 5); R = (st >> 1) * 16 + swz / 64; C = (st & 1) * 32 + (swz % 64) / 2; }
__host__ __device__ __forceinline__ int perm32(int rho) { const int n = rho >> 4, i = rho & 15; return 8 * (i >> 2) + 4 * n + (i & 3); }

struct Unit { int pm, pn; };
struct Gemm { const bf16_t* A; const bf16_t* Bt; int M, N, K; };

struct StaticOrder {
    int nM, nN, nwg, G, c;
    __host__ __device__ void init(int M, int N, int G_, int c_) { nM = M / BM; nN = N / BM; nwg = nM * nN; G = G_; c = c_; }
    __host__ __device__ bool next(int i, Unit& u) const {
        const long L = (long)i * G + c; if (L >= nwg) return false;
        int wgid = (int)L; { const int q = nwg / NXCD, r = nwg % NXCD, xcd = wgid % NXCD, off = wgid / NXCD; wgid = (xcd < r ? xcd * (q + 1) : r * (q + 1) + (xcd - r) * q) + off; }
        const int nig = WGM * nN, gid = wgid / nig, fm = gid * WGM, gsz = (nM - fm) < WGM ? (nM - fm) : WGM;
        u.pm = fm + ((wgid % nig) % gsz); u.pn = (wgid % nig) / gsz; return true;
    }
    __device__ __forceinline__ void a_ready(const Unit&) const {}
    __device__ __forceinline__ void done(const Unit&) const {}
};

__device__ __forceinline__ unsigned cvt_pk_bf16(float lo, float hi) { unsigned r; asm volatile("v_cvt_pk_bf16_f32 %0, %1, %2" : "=v"(r) : "v"(lo), "v"(hi)); return r; }
__device__ __forceinline__ float bf_lo(unsigned w) { return __uint_as_float(w << 16); }
__device__ __forceinline__ float bf_hi(unsigned w) { return __uint_as_float(w & 0xffff0000u); }
__device__ __forceinline__ float sigmoid_f(float x) { return __builtin_amdgcn_rcpf(1.0f + __builtin_amdgcn_exp2f(-1.4426950408889634f * x)); }
__device__ __forceinline__ u32x4 pack8(const f32x4 a, const f32x4 b) { u32x4 w; w.x = cvt_pk_bf16(a[0], a[1]); w.y = cvt_pk_bf16(a[2], a[3]); w.z = cvt_pk_bf16(b[0], b[1]); w.w = cvt_pk_bf16(b[2], b[3]); return w; }

struct EpiF32 {
    static constexpr bool PERM = false, AFTER_DRAIN = false;
    float* C; int ldc;
    __device__ __forceinline__ void operator()(const f32x4 (&acc)[2][2][4][2], const Unit& u, int wr, int wc, int fr, int fq) const {
        const int row0 = u.pm * BM + wr * 64 + fr, col0 = u.pn * BM + wc * 32 + 4 * fq;
#pragma unroll
        for (int ai = 0; ai < 2; ++ai)
#pragma unroll
            for (int m = 0; m < 4; ++m) { float* rowp = C + (size_t)(row0 + ai * HALF + m * 16) * ldc + col0;
#pragma unroll
                for (int bj = 0; bj < 2; ++bj)
#pragma unroll
                    for (int n = 0; n < 2; ++n) *(f32x4*)(rowp + bj * HALF + n * 16) = acc[ai][bj][m][n]; }
    }
};

struct EpiSwiGLU {
    static constexpr bool PERM = true, AFTER_DRAIN = false;
    bf16_t* O; int ldc;
    __device__ __forceinline__ void operator()(const f32x4 (&acc)[2][2][4][2], const Unit& u, int wr, int wc, int fr, int fq) const {
        const int row0 = u.pm * BM + wr * 64 + fr, col0 = u.pn * HALF + wc * 32 + 8 * fq;
#pragma unroll
        for (int ai = 0; ai < 2; ++ai)
#pragma unroll
            for (int m = 0; m < 4; ++m) { bf16_t* p = O + (size_t)(row0 + ai * HALF + m * 16) * ldc + col0;
                f32x4 o[2];
#pragma unroll
                for (int n = 0; n < 2; ++n) { const f32x4 g = acc[ai][0][m][n], up = acc[ai][1][m][n];
#pragma unroll
                    for (int e = 0; e < 4; ++e) o[n][e] = g[e] * sigmoid_f(g[e]) * up[e]; }
                *(u32x4*)p = pack8(o[0], o[1]); }
    }
};

struct EpiWin {
    static constexpr bool PERM = true, AFTER_DRAIN = false;
    bf16_t *U, *CB, *Q, *SGA, *SGB, *KB, *VB; float *stc, *kw, *vw; float qscale;
    __device__ __forceinline__ void operator()(const f32x4 (&acc)[2][2][4][2], const Unit& u, int wr, int wc, int fr, int fq) const {
        const int row0 = u.pm * BM + wr * 64 + fr, pn = u.pn, cw = wc * 32 + 8 * fq;
        if (pn < 8) {
#pragma unroll
            for (int ai = 0; ai < 2; ++ai)
#pragma unroll
                for (int m = 0; m < 4; ++m) { const int row = row0 + ai * HALF + m * 16, col = pn * HALF + cw; const int t = row & (SEQ - 1), b = row >> 13;
                    const f32x4 o0 = acc[ai][0][m][0] * acc[ai][1][m][0], o1 = acc[ai][0][m][1] * acc[ai][1][m][1];
                    *(u32x4*)(U + (size_t)row * DM + col) = pack8(o0, o1);
                    if (t >= SEQ - 2) { float* s = stc + (size_t)(b * 2 + (t - (SEQ - 2))) * DM + col; *(f32x4*)s = o0; *(f32x4*)(s + 4) = o1; } }
        } else {
            bf16_t* dst; int ld, cbase; int kind;
            float* win = nullptr;
            if (pn < 12) { dst = CB; ld = DM; cbase = (pn - 8) * BM; kind = 0; }
            else if (pn < 16) { dst = Q; ld = DM; cbase = (pn - 12) * BM; kind = 1; }
            else if (pn == 16) { dst = KB; ld = NKV; cbase = 0; kind = 3; win = kw; }
            else if (pn == 17) { dst = VB; ld = NKV; cbase = 0; kind = 3; win = vw; }
            else if (pn < 22) { dst = SGA; ld = DM; cbase = (pn - 18) * BM; kind = 2; }
            else { dst = SGB; ld = DM; cbase = (pn - 22) * BM; kind = 2; }
#pragma unroll
            for (int ai = 0; ai < 2; ++ai)
#pragma unroll
                for (int m = 0; m < 4; ++m) { const int row = row0 + ai * HALF + m * 16; const int t = row & (SEQ - 1), b = row >> 13;
#pragma unroll
                    for (int bj = 0; bj < 2; ++bj) { f32x4 v0 = acc[ai][bj][m][0], v1 = acc[ai][bj][m][1]; const int col = cbase + bj * HALF + cw;
                        if (kind == 1) { v0 = v0 * qscale; v1 = v1 * qscale; }
                        if (kind == 2) {
#pragma unroll
                            for (int e = 0; e < 4; ++e) { v0[e] = sigmoid_f(v0[e]); v1[e] = sigmoid_f(v1[e]); } }
                        *(u32x4*)(dst + (size_t)row * ld + col) = pack8(v0, v1);
                        if (kind == 3 && t >= SEQ - 128) { float* s = win + (size_t)(b * 128 + (t - (SEQ - 128))) * NKV + col; *(f32x4*)s = v0; *(f32x4*)(s + 4) = v1; } } }
        }
    }
};

struct EpiGate {
    static constexpr bool PERM = true, AFTER_DRAIN = false;
    const bf16_t* G; const bf16_t* T; bf16_t* O; int pass;
    __device__ __forceinline__ void operator()(const f32x4 (&acc)[2][2][4][2], const Unit& u, int wr, int wc, int fr, int fq) const {
        const int row0 = u.pm * BM + wr * 64 + fr, col0 = u.pn * BM + wc * 32 + 8 * fq;
#pragma unroll
        for (int ai = 0; ai < 2; ++ai)
#pragma unroll
            for (int m = 0; m < 4; ++m)
#pragma unroll
                for (int bj = 0; bj < 2; ++bj) { const size_t off = (size_t)(row0 + ai * HALF + m * 16) * DM + col0 + bj * HALF;
                    const u32x4 g = *(const u32x4*)(G + off); f32x4 v0 = acc[ai][bj][m][0], v1 = acc[ai][bj][m][1];
                    v0[0] *= bf_lo(g.x); v0[1] *= bf_hi(g.x); v0[2] *= bf_lo(g.y); v0[3] *= bf_hi(g.y); v1[0] *= bf_lo(g.z); v1[1] *= bf_hi(g.z); v1[2] *= bf_lo(g.w); v1[3] *= bf_hi(g.w);
                    if (pass == 1) { const u32x4 t = *(const u32x4*)(T + off);
                        v0[0] += bf_lo(t.x); v0[1] += bf_hi(t.x); v0[2] += bf_lo(t.y); v0[3] += bf_hi(t.y); v1[0] += bf_lo(t.z); v1[1] += bf_hi(t.z); v1[2] += bf_lo(t.w); v1[3] += bf_hi(t.w); }
                    *(u32x4*)(O + off) = pack8(v0, v1); }
    }
};

template <class Epi, class Sched, bool ALIGN_EPI = false, bool SP2 = false>
__device__ __forceinline__ void gemm_phase(PG8_LAS unsigned char* lds, const Gemm g, const Sched& S, const Epi& E, const int wave_s) {
    const int tid = opq_tid(), wid = __builtin_amdgcn_readfirstlane(tid >> 6), lane = tid & 63, wr = wid >> 2, wc = wid & 3, fr = lane & 15, fq = lane >> 4;
    const int K = g.K, nt = K / BK;
    unsigned voffA[2], voffB[2];
#pragma unroll
    for (int i = 0; i < 2; ++i) { int R, C; stage_rc(tid * 16 + i * 8192, R, C); const int Rb = Epi::PERM ? ((R & ~31) + perm32(R & 31)) : R;
        voffA[i] = (unsigned)(R * K + C) * 2u; voffB[i] = (unsigned)(Rb * K + C) * 2u; }
    const size_t kstep = (size_t)(BK * 2);
    const size_t hstep = (size_t)HALF * K * 2;
    const size_t tstep = 2 * hstep;
    const unsigned ldsw = (unsigned)wid * 1024u;
    const int aoff = lds_byte(wr * 64 + fr, fq * 8), boff = lds_byte(wc * 32 + fr, fq * 8);
#define PG8_SA(b, h) (((b) * 2 + (h)) * HTB)
#define PG8_SB(b, h) ((4 + (b) * 2 + (h)) * HTB)
#define PG8_STAGE(bufoff, gbase, voff) do { _Pragma("unroll") for (int _i = 0; _i < 2; ++_i) \
        __builtin_amdgcn_global_load_lds((const unsigned*)((const char*)(gbase) + (voff)[_i]), (PG8_LAS unsigned*)(lds + (bufoff) + ldsw + _i * 8192), 16, 0, 0); } while (0)
#define PG8_LDA(dst, b, h) do { _Pragma("unroll") for (int m = 0; m < 4; ++m) _Pragma("unroll") for (int k = 0; k < 2; ++k) dst[m][k] = *(const PG8_LAS bf16x8*)(lds + PG8_SA(b, h) + aoff + m * 2048 + k * 1024); } while (0)
#define PG8_LDB(dst, b, h) do { _Pragma("unroll") for (int n = 0; n < 2; ++n) _Pragma("unroll") for (int k = 0; k < 2; ++k) dst[n][k] = *(const PG8_LAS bf16x8*)(lds + PG8_SB(b, h) + boff + n * 2048 + k * 1024); } while (0)
#define PG8_MMA(ai, bj, At, Bt) do { __builtin_amdgcn_s_setprio(1); _Pragma("unroll") for (int m = 0; m < 4; ++m) _Pragma("unroll") for (int n = 0; n < 2; ++n) _Pragma("unroll") for (int k = 0; k < 2; ++k) \
        acc[ai][bj][m][n] = __builtin_amdgcn_mfma_f32_16x16x32_bf16(Bt[n][k], At[m][k], acc[ai][bj][m][n], 0, 0, 0); __builtin_amdgcn_s_setprio(0); } while (0)
#define PG8_WAIT_V(n) asm volatile("s_waitcnt vmcnt(" #n ")" ::: "memory")
#define PG8_WAIT_L(n) asm volatile("s_waitcnt lgkmcnt(" #n ")" ::: "memory")
#define PG8_BAR __builtin_amdgcn_s_barrier()
#define PG8_SCHED __builtin_amdgcn_sched_barrier(0)
    Unit cur, nxt; int ui = 0;
    if (!S.next(0, cur)) return;
    f32x4 acc[2][2][4][2];
#pragma unroll
    for (int a = 0; a < 2; ++a)
#pragma unroll
        for (int b = 0; b < 2; ++b)
#pragma unroll
            for (int m = 0; m < 4; ++m)
#pragma unroll
                for (int n = 0; n < 2; ++n) acc[a][b][m][n] = (f32x4){0.f, 0.f, 0.f, 0.f};
    bf16x8 At[4][2], B0[2][2], B1[2][2];
    const char* cA = (const char*)g.A + (size_t)cur.pm * tstep; const char* cB = (const char*)g.Bt + (size_t)cur.pn * tstep;
    S.a_ready(cur);
    if constexpr (SP2) {
        PG8_STAGE(PG8_SB(0, 0), cB, voffB); PG8_STAGE(PG8_SB(0, 1), cB + hstep, voffB); PG8_STAGE(PG8_SA(0, 0), cA, voffA); PG8_STAGE(PG8_SA(0, 1), cA + hstep, voffA);
        if (wr == 1) PG8_BAR;
        PG8_WAIT_V(2); PG8_BAR;
        PG8_STAGE(PG8_SB(1, 0), cB + kstep, voffB); PG8_STAGE(PG8_SA(1, 0), cA + kstep, voffA); PG8_STAGE(PG8_SB(1, 1), cB + hstep + kstep, voffB);
        PG8_WAIT_V(6); PG8_BAR;
    } else {
        PG8_STAGE(PG8_SB(0, 0), cB, voffB); PG8_STAGE(PG8_SA(0, 0), cA, voffA); PG8_STAGE(PG8_SB(0, 1), cB + hstep, voffB); PG8_STAGE(PG8_SA(0, 1), cA + hstep, voffA);
        if (wr == 1) PG8_BAR;
        PG8_WAIT_V(4); PG8_BAR;
        PG8_STAGE(PG8_SB(1, 0), cB + kstep, voffB); PG8_STAGE(PG8_SA(1, 0), cA + kstep, voffA); PG8_STAGE(PG8_SB(1, 1), cB + hstep + kstep, voffB);
        PG8_WAIT_V(6); PG8_BAR;
    }
    for (;;) {
        const bool has_next = S.next(ui + 1, nxt);
        const char* nA = has_next ? (const char*)g.A + (size_t)nxt.pm * tstep : cA; const char* nB = has_next ? (const char*)g.Bt + (size_t)nxt.pn * tstep : cB;
        for (int t = 0; t < nt; t += 2) {
            const bool last = (t == nt - 2);
            const char* a1 = cA + (size_t)(t + 1) * kstep;
            const char* a2 = last ? nA : cA + (size_t)(t + 2) * kstep; const char* b2 = last ? nB : cB + (size_t)(t + 2) * kstep;
            const char* a3 = a2 + kstep; const char* b3 = b2 + kstep;
            if (last && has_next) S.a_ready(nxt);
            if constexpr (SP2) {
            PG8_LDB(B0, 0, 0); PG8_LDB(B1, 0, 1); PG8_SCHED; PG8_LDA(At, 0, 0); PG8_STAGE(PG8_SA(1, 1), a1 + hstep, voffA);
            PG8_WAIT_V(8); PG8_WAIT_L(0); PG8_BAR; PG8_MMA(0, 0, At, B0); PG8_MMA(0, 1, At, B1); PG8_BAR; PG8_SCHED;
            PG8_LDA(At, 0, 1); PG8_STAGE(PG8_SB(0, 0), b2, voffB); PG8_STAGE(PG8_SB(0, 1), b2 + hstep, voffB); PG8_STAGE(PG8_SA(0, 0), a2, voffA);
            PG8_WAIT_V(8); PG8_WAIT_L(0); PG8_BAR; PG8_MMA(1, 0, At, B0); PG8_MMA(1, 1, At, B1); PG8_BAR; PG8_SCHED;
            PG8_LDB(B0, 1, 0); PG8_LDB(B1, 1, 1); PG8_SCHED; PG8_LDA(At, 1, 0); PG8_STAGE(PG8_SA(0, 1), a2 + hstep, voffA);
            PG8_WAIT_V(8); PG8_WAIT_L(0); PG8_BAR; PG8_MMA(0, 0, At, B0); PG8_MMA(0, 1, At, B1); PG8_BAR; PG8_SCHED;
            PG8_LDA(At, 1, 1); PG8_STAGE(PG8_SB(1, 0), b3, voffB); PG8_STAGE(PG8_SB(1, 1), b3 + hstep, voffB); PG8_STAGE(PG8_SA(1, 0), a3, voffA);
            PG8_WAIT_V(8); PG8_WAIT_L(0); PG8_BAR; PG8_MMA(1, 0, At, B0); PG8_MMA(1, 1, At, B1); PG8_BAR; PG8_SCHED;
            } else {
            PG8_LDB(B0, 0, 0); PG8_SCHED; PG8_LDA(At, 0, 0); PG8_STAGE(PG8_SA(1, 1), a1 + hstep, voffA);
            PG8_WAIT_L(8); PG8_BAR; PG8_WAIT_L(0); PG8_MMA(0, 0, At, B0); PG8_BAR; PG8_SCHED;
            PG8_LDB(B1, 0, 1); PG8_STAGE(PG8_SB(0, 0), b2, voffB);
            PG8_BAR; PG8_WAIT_L(0); PG8_MMA(0, 1, At, B1); PG8_BAR;
            PG8_LDA(At, 0, 1); PG8_STAGE(PG8_SA(0, 0), a2, voffA);
            PG8_BAR; PG8_WAIT_L(0); PG8_MMA(1, 0, At, B0); PG8_BAR; PG8_SCHED;
            PG8_STAGE(PG8_SB(0, 1), b2 + hstep, voffB);
            PG8_WAIT_V(6); PG8_BAR; PG8_MMA(1, 1, At, B1); PG8_BAR;
            PG8_LDB(B0, 1, 0); PG8_SCHED; PG8_LDA(At, 1, 0); PG8_STAGE(PG8_SA(0, 1), a2 + hstep, voffA);
            PG8_WAIT_L(8); PG8_BAR; PG8_WAIT_L(0); PG8_MMA(0, 0, At, B0); PG8_BAR; PG8_SCHED;
            PG8_LDB(B1, 1, 1); PG8_STAGE(PG8_SB(1, 0), b3, voffB);
            PG8_BAR; PG8_WAIT_L(0); PG8_MMA(0, 1, At, B1); PG8_BAR;
            PG8_LDA(At, 1, 1); PG8_STAGE(PG8_SA(1, 0), a3, voffA);
            PG8_BAR; PG8_WAIT_L(0); PG8_MMA(1, 0, At, B0); PG8_BAR; PG8_SCHED;
            PG8_STAGE(PG8_SB(1, 1), b3 + hstep, voffB);
            PG8_WAIT_V(6); PG8_BAR; PG8_MMA(1, 1, At, B1); PG8_BAR;
            }
        }
        if constexpr (ALIGN_EPI) { if (wr == 0) PG8_BAR; }
        if constexpr (!Epi::AFTER_DRAIN) { E(acc, cur, wr, wc, fr, fq); S.done(cur); }
        if (!has_next) break;
#pragma unroll
        for (int a = 0; a < 2; ++a)
#pragma unroll
            for (int b = 0; b < 2; ++b)
#pragma unroll
                for (int m = 0; m < 4; ++m)
#pragma unroll
                    for (int n = 0; n < 2; ++n) acc[a][b][m][n] = (f32x4){0.f, 0.f, 0.f, 0.f};
        cur = nxt; cA = nA; cB = nB; ++ui;
        if constexpr (ALIGN_EPI) { if (wr == 1) PG8_BAR; }
    }
    PG8_WAIT_V(0);
    if constexpr (!ALIGN_EPI) { if (wr == 0) PG8_BAR; }
    PG8_BAR;
    if constexpr (Epi::AFTER_DRAIN) { E.fused(acc, cur, wr, wc, fr, fq, lds, wid, lane); S.done(cur); }
#undef PG8_SA
#undef PG8_SB
#undef PG8_STAGE
#undef PG8_LDA
#undef PG8_LDB
#undef PG8_MMA
#undef PG8_WAIT_V
#undef PG8_WAIT_L
#undef PG8_BAR
#undef PG8_SCHED
}
}

#ifndef PG8_SP2
#define PG8_SP2 true
#endif
#ifndef PG8_ALIGN
#define PG8_ALIGN true
#endif

#define GAS __attribute__((address_space(1)))
#define LAS __attribute__((address_space(3)))
typedef unsigned short bf16;
typedef unsigned v4u __attribute__((ext_vector_type(4)));
typedef unsigned v2u __attribute__((ext_vector_type(2)));
typedef float f32x4 __attribute__((ext_vector_type(4)));
typedef float f32x16 __attribute__((ext_vector_type(16)));
typedef short bf16x8 __attribute__((ext_vector_type(8)));
typedef short s16x4 __attribute__((ext_vector_type(4)));
typedef GAS unsigned gu32;
#define RLX_AGENT __ATOMIC_RELAXED, __HIP_MEMORY_SCOPE_AGENT
#define LDS_WAIT() asm volatile("s_waitcnt lgkmcnt(0)" ::: "memory")
#define VM_WAIT() asm volatile("s_waitcnt vmcnt(0)" ::: "memory")
__device__ __forceinline__ unsigned f2bf(float f) { unsigned u = __builtin_bit_cast(unsigned, f); return (u + 0x7fffu + ((u >> 16) & 1u)) >> 16; }
__device__ __forceinline__ unsigned pk2(float lo, float hi) { return f2bf(lo) | (f2bf(hi) << 16); }
__device__ __forceinline__ float bflo(unsigned w) { return __uint_as_float(w << 16); }
__device__ __forceinline__ float bfhi(unsigned w) { return __uint_as_float(w & 0xffff0000u); }
__device__ __forceinline__ float wave_sum(float v) {
#pragma unroll
    for (int o = 1; o < 64; o <<= 1) v += __shfl_xor(v, o);
    return v;
}
__device__ __forceinline__ float wave_max(float v) {
#pragma unroll
    for (int o = 1; o < 64; o <<= 1) v = fmaxf(v, __shfl_xor(v, o));
    return v;
}

constexpr size_t MiB = 1u << 20;
constexpr size_t WS_CTL = 0, CTL_ZERO_BYTES = 1 * MiB;
constexpr size_t WS_W = 1 * MiB, W_LAYER = 52 * MiB;
constexpr size_t WO_GU1 = 0, WO_D1 = 11 * MiB, WO_IN = 16 * MiB + MiB / 2, WO_WC = 29 * MiB + MiB / 2, WO_WA = 31 * MiB + MiB / 2, WO_WO = 33 * MiB + MiB / 2, WO_GU2 = 35 * MiB + MiB / 2, WO_D2 = 46 * MiB + MiB / 2;
static_assert(WO_D1 - WO_GU1 == (size_t)NGU * DM * 2 && WO_IN - WO_D1 == (size_t)DM * DFF * 2 && WO_WC - WO_IN == (size_t)NIN * DM * 2 && WO_WA - WO_WC == (size_t)DM * DM * 2 && WO_GU2 - WO_WO == (size_t)DM * DM * 2 && WO_D2 - WO_GU2 == (size_t)NGU * DM * 2 && W_LAYER - WO_D2 == (size_t)DM * DFF * 2, "weight map");
constexpr size_t RB = (size_t)MT * DM * 2;
constexpr size_t WS_H = WS_W + NLAYER * W_LAYER;
constexpr size_t WS_P = WS_H + RB;
constexpr size_t WS_U = WS_P, WS_CB = WS_P + RB, WS_Q = WS_P + 2 * RB, WS_SGA = WS_P + 3 * RB, WS_SGB = WS_P + 4 * RB, WS_KB = WS_P + 5 * RB, WS_VB = WS_KB + (size_t)MT * NKV * 2, WS_END = WS_VB + (size_t)MT * NKV * 2;
constexpr size_t WS_ACT = WS_P;
constexpr size_t WS_DF = WS_SGA;
constexpr size_t WS_DX = WS_U;
static_assert(WS_ACT + (size_t)MT * DFF * 2 <= WS_SGA && WS_DF + (size_t)MT * DM * 4 <= WS_KB && WS_DX + (size_t)MT * DM * 4 <= WS_Q, "overlays");
static_assert(WS_END <= 338 * MiB, "workspace budget");
constexpr size_t O_YP = 0, O_YS = (size_t)MP * DM, O_STP = O_YS + (size_t)MS * DM, O_KWP = O_STP + (size_t)NLAYER * NBATCH * 2 * DM, O_VWP = O_KWP + (size_t)NLAYER * NBATCH * 128 * NKV,
                 O_STS = O_VWP + (size_t)NLAYER * NBATCH * 128 * NKV, O_KWS = O_STS + (size_t)NLAYER * MS * 2 * DM, O_VWS = O_KWS + (size_t)NLAYER * MS * 128 * NKV, O_END = O_VWS + (size_t)NLAYER * MS * 128 * NKV;
static_assert(O_END == 34480128, "output size");
constexpr int CW_BAR = 4096;

constexpr int RING_OFF = 0, RING_BYTES = 131072;
constexpr int LDSCTL_OFF = RING_BYTES, MISC_OFF = LDSCTL_OFF + 320;
constexpr int LDS_BYTES = 147456;
constexpr int NWAVES = 8;

#define XB_TMO      128
#define XB_XCNT(j)  (256  + 64 * (j))
#define XB_XSUB(j)  (1280 + 64 * (j))
#define XB_XGEN(j)  (2304 + 64 * (j))
#define XB_TOP      3328
#define XB_TOPGEN   3392
#define XCD_BAR_WORDS 3456
#define XB_SPIN_CAP (1u << 18)

__device__ __forceinline__ unsigned xb_ld(unsigned* p)              { return __hip_atomic_load(p, __ATOMIC_RELAXED, __HIP_MEMORY_SCOPE_AGENT); }
__device__ __forceinline__ unsigned xb_add(unsigned* p, unsigned v) { return __hip_atomic_fetch_add(p, v, __ATOMIC_RELAXED, __HIP_MEMORY_SCOPE_AGENT); }
__device__ __forceinline__ unsigned xb_xcc_id() { return (unsigned)__builtin_amdgcn_s_getreg((3 << 11) | 20) & 0xFu; }
#define XB_SPIN(cond, bar) do { unsigned _sp = 0; while (cond) { __builtin_amdgcn_s_sleep(1); \
    if ((++_sp & 255u) == 0u) { if (xb_ld(&(bar)[XB_TMO])) break; if (_sp > XB_SPIN_CAP) { atomicAdd(&(bar)[XB_TMO], 1u); break; } } } } while (0)

struct XcdBarrier {
    unsigned* bar; unsigned x;
    volatile LAS unsigned* st;
};

__device__ __forceinline__ XcdBarrier xcd_barrier_post(unsigned* bar, volatile LAS unsigned* st) {
    XcdBarrier b; b.bar = bar; b.x = xb_xcc_id(); b.st = st;
    if (threadIdx.x == 0) (void)xb_add(&bar[XB_XCNT(b.x)], 1u);
    return b;
}
__device__ __forceinline__ void xcd_barrier_complete(unsigned* bar, unsigned x, unsigned& nloc, unsigned& nx) {
    const unsigned G = gridDim.x * gridDim.y * gridDim.z;
    unsigned sum, cnt, mine, sp = 0u;
    for (;;) {
        sum = 0u; cnt = 0u; mine = 0u;
#pragma unroll
        for (unsigned j = 0; j < 16; ++j) { const unsigned c = xb_ld(&bar[XB_XCNT(j)]); sum += c; cnt += (c > 0u) ? 1u : 0u; mine = (j == x) ? c : mine; }
        if (sum == G) break;
        __builtin_amdgcn_s_sleep(1);
        if ((++sp & 255u) == 0u) { if (xb_ld(&bar[XB_TMO])) break; if (sp > XB_SPIN_CAP) { atomicAdd(&bar[XB_TMO], 1u); break; } }
    }
    nloc = mine > 0u ? mine : 1u; nx = cnt > 0u ? cnt : 1u;
}

__device__ __forceinline__ void xcd_barrier(const XcdBarrier& b) {
    asm volatile("s_waitcnt vmcnt(0)" ::: "memory");
    __syncthreads();
    if (threadIdx.x == 0) {
        unsigned* bar = b.bar;
        __builtin_amdgcn_s_waitcnt(0);
        unsigned nloc = b.st[0], nx = b.st[1];
        if (nloc == 0u) { xcd_barrier_complete(bar, b.x, nloc, nx); b.st[0] = nloc; b.st[1] = nx; }
        const unsigned old = xb_add(&bar[XB_XSUB(b.x)], 1u);
        const unsigned gen = old / nloc;
        if (old + 1u == (gen + 1u) * nloc) {
            __builtin_amdgcn_fence(__ATOMIC_RELEASE, "agent");
            asm volatile("s_waitcnt vmcnt(0)" ::: "memory");
            const unsigned og = xb_add(&bar[XB_TOP], 1u);
            const unsigned tg = og / nx;
            if (og + 1u == (tg + 1u) * nx) xb_add(&bar[XB_TOPGEN], 1u);
            else XB_SPIN(xb_ld(&bar[XB_TOPGEN]) == tg, bar);
            __builtin_amdgcn_fence(__ATOMIC_ACQUIRE, "agent");
            xb_add(&bar[XB_XGEN(b.x)], 1u);
            asm volatile("s_waitcnt vmcnt(0)" ::: "memory");
        } else {
            XB_SPIN(xb_ld(&bar[XB_XGEN(b.x)]) == gen, bar);
            __builtin_amdgcn_fence(__ATOMIC_ACQUIRE, "agent");
            asm volatile("s_waitcnt vmcnt(0)" ::: "memory");
        }
    }
    __syncthreads();
}

struct Frame {
    LAS unsigned char* lds;
    int wave;
    int vcu, G;
    const __attribute__((address_space(4))) struct Args* ap;
};
struct Args { const float* in[17]; float* out; unsigned char* ws; int ph_lo, ph_hi, li, pad; };
enum { I_XP = 0, I_XS, I_STC, I_CK, I_CV, I_RB, I_NG, I_GU1, I_D1, I_IN, I_CW, I_SINK, I_WC, I_WA, I_WO, I_GU2, I_D2 };

__device__ __forceinline__ int colmap(int type, int np) {
    if (type == 0) return np;
    const int pn = np >> 8, r = np & 255;
    if (type == 1) return (r < 128) ? (128 * pn + r) : (DFF + 128 * pn + (r - 128));
    if (pn < 8) return (r < 128) ? (1024 + 128 * pn + r) : (2048 + 128 * pn + (r - 128));
    if (pn < 12) return 256 * (pn - 8) + r;
    if (pn < 16) return 3072 + 256 * (pn - 12) + r;
    if (pn == 16) return 4096 + r;
    if (pn == 17) return 4352 + r;
    if (pn < 22) return 4608 + 256 * (pn - 18) + r;
    return 5632 + 256 * (pn - 22) + r;
}
__device__ __forceinline__ void p0_transpose_item(const float* W, int K, int N, bf16* WT, int type, LAS float* scr, int item, int lane) {
    const int nblk = N / 32, kb = item / nblk, nb = item % nblk, k0 = 64 * kb, nd0 = 32 * nb, ns0 = colmap(type, nd0);
#pragma unroll 8
    for (int i = 0; i < 32; ++i) { const int kk = 2 * i + (lane >> 5); scr[kk * 33 + (lane & 31)] = W[(size_t)(k0 + kk) * N + ns0 + (lane & 31)]; }
    LDS_WAIT(); asm volatile("" ::: "memory");
    const int c = lane & 7;
#pragma unroll
    for (int j = 0; j < 4; ++j) { const int n = (lane >> 3) + 8 * j; const LAS float* s = scr + (8 * c) * 33 + n;
        v4u o; o.x = pk2(s[0 * 33], s[1 * 33]); o.y = pk2(s[2 * 33], s[3 * 33]); o.z = pk2(s[4 * 33], s[5 * 33]); o.w = pk2(s[6 * 33], s[7 * 33]);
        *(GAS v4u*)(WT + (size_t)(nd0 + n) * K + k0 + 8 * c) = o; }
    LDS_WAIT(); asm volatile("" ::: "memory");
}
__device__ __forceinline__ void rms_row_to_bf16(const float* xrow, const float* g, bf16* orow, int lane) {
    const GAS f32x4* xr = (const GAS f32x4*)xrow + lane; const GAS f32x4* gr = (const GAS f32x4*)g + lane;
    f32x4 v[4]; float s = 0.f;
#pragma unroll
    for (int j = 0; j < 4; ++j) { v[j] = xr[64 * j]; s += (v[j].x * v[j].x + v[j].y * v[j].y) + (v[j].z * v[j].z + v[j].w * v[j].w); }
    const float r = 1.0f / sqrtf(wave_sum(s) * (1.f / DM) + RMS_EPS);
    GAS v2u* o8 = (GAS v2u*)orow + lane;
#pragma unroll
    for (int j = 0; j < 4; ++j) { const f32x4 gg = gr[64 * j]; v2u w; w.x = pk2(v[j].x * r * gg.x, v[j].y * r * gg.y); w.y = pk2(v[j].z * r * gg.z, v[j].w * r * gg.w); o8[64 * j] = w; }
}
__device__ __forceinline__ void p0_prologue(Frame& F) {
    const int lane = opq_lane();
    LAS float* scr = (LAS float*)(F.lds + RING_OFF + F.wave * 16384);
    const int gw = F.vcu * NWAVES + F.wave, NGW = F.G * NWAVES;
    constexpr int I_GU = (DM / 64) * (NGU / 32), I_DN = (DFF / 64) * (DM / 32), I_WI = (DM / 64) * (NIN / 32), I_SQ = (DM / 64) * (DM / 32);
    constexpr int PER_LAYER = 2 * I_GU + 2 * I_DN + I_WI + 3 * I_SQ;
    for (int it = gw; it < NLAYER * PER_LAYER; it += NGW) {
        const int l = it / PER_LAYER; int r = it % PER_LAYER;
        bf16* wl = (bf16*)(F.ap->ws + WS_W + (size_t)l * W_LAYER);
        if (r < I_GU) { p0_transpose_item(F.ap->in[I_GU1] + (size_t)l * DM * NGU, DM, NGU, (bf16*)((unsigned char*)wl + WO_GU1), 1, scr, r, lane); continue; } r -= I_GU;
        if (r < I_DN) { p0_transpose_item(F.ap->in[I_D1] + (size_t)l * DFF * DM, DFF, DM, (bf16*)((unsigned char*)wl + WO_D1), 0, scr, r, lane); continue; } r -= I_DN;
        if (r < I_WI) { p0_transpose_item(F.ap->in[I_IN] + (size_t)l * DM * NIN, DM, NIN, (bf16*)((unsigned char*)wl + WO_IN), 2, scr, r, lane); continue; } r -= I_WI;
        if (r < I_SQ) { p0_transpose_item(F.ap->in[I_WC] + (size_t)l * DM * DM, DM, DM, (bf16*)((unsigned char*)wl + WO_WC), 0, scr, r, lane); continue; } r -= I_SQ;
        if (r < I_SQ) { p0_transpose_item(F.ap->in[I_WA] + (size_t)l * DM * DM, DM, DM, (bf16*)((unsigned char*)wl + WO_WA), 0, scr, r, lane); continue; } r -= I_SQ;
        if (r < I_SQ) { p0_transpose_item(F.ap->in[I_WO] + (size_t)l * DM * DM, DM, DM, (bf16*)((unsigned char*)wl + WO_WO), 0, scr, r, lane); continue; } r -= I_SQ;
        if (r < I_GU) { p0_transpose_item(F.ap->in[I_GU2] + (size_t)l * DM * NGU, DM, NGU, (bf16*)((unsigned char*)wl + WO_GU2), 1, scr, r, lane); continue; } r -= I_GU;
        p0_transpose_item(F.ap->in[I_D2] + (size_t)l * DFF * DM, DFF, DM, (bf16*)((unsigned char*)wl + WO_D2), 0, scr, r, lane);
    }
    bf16* H = (bf16*)(F.ap->ws + WS_H);
    for (int m = gw; m < MT; m += NGW) {
        const float* xr = (m < MP) ? F.ap->in[I_XP] + (size_t)m * DM : F.ap->in[I_XS] + (size_t)(m - MP) * DM;
        rms_row_to_bf16(xr, F.ap->in[I_NG], H + (size_t)m * DM, lane);
    }
}

__device__ __forceinline__ void row_phase(Frame& F, const float* D, const float* base_p, const float* base_s, const float* ga, const float* gb, float s) {
    const int gw = F.vcu * NWAVES + F.wave, NGW = F.G * NWAVES, lane = opq_lane();
    bf16* H = (bf16*)(F.ap->ws + WS_H);
    for (int m = gw; m < MT; m += NGW) {
        const float* brow = (m < MP) ? base_p + (size_t)m * DM : base_s + (size_t)(m - MP) * DM;
        float* orow = (m < MP) ? F.ap->out + O_YP + (size_t)m * DM : F.ap->out + O_YS + (size_t)(m - MP) * DM;
        const GAS f32x4* dr = (const GAS f32x4*)(D + (size_t)m * DM) + lane; const GAS f32x4* br = (const GAS f32x4*)brow + lane;
        const GAS f32x4* g1 = (const GAS f32x4*)ga + lane;
        f32x4 d[4], x[4]; float ss = 0.f;
#pragma unroll
        for (int j = 0; j < 4; ++j) { d[j] = dr[64 * j]; x[j] = br[64 * j]; ss += (d[j].x * d[j].x + d[j].y * d[j].y) + (d[j].z * d[j].z + d[j].w * d[j].w); }
        const float r1 = s / sqrtf(wave_sum(ss) * (1.f / DM) + RMS_EPS);
        float s2 = 0.f;
#pragma unroll
        for (int j = 0; j < 4; ++j) { const f32x4 g = g1[64 * j]; x[j] = x[j] + d[j] * r1 * g; ((GAS f32x4*)orow + lane)[64 * j] = x[j];
            s2 += (x[j].x * x[j].x + x[j].y * x[j].y) + (x[j].z * x[j].z + x[j].w * x[j].w); }
        if (gb) {
            const float r2 = 1.0f / sqrtf(wave_sum(s2) * (1.f / DM) + RMS_EPS);
            const GAS f32x4* g2 = (const GAS f32x4*)gb + lane; GAS v2u* o8 = (GAS v2u*)(H + (size_t)m * DM) + lane;
#pragma unroll
            for (int j = 0; j < 4; ++j) { const f32x4 g = g2[64 * j]; v2u w; w.x = pk2(x[j].x * r2 * g.x, x[j].y * r2 * g.y); w.y = pk2(x[j].z * r2 * g.z, x[j].w * r2 * g.w); o8[64 * j] = w; }
        }
    }
}

template <int G> struct SmB { const bf16* p[G]; };
template <int G> __device__ __forceinline__ void sm_gemm(const bf16* A  , int lda, const SmB<G> B  , int K, int lane, f32x4 (&acc)[G]) {
    const int r = lane & 15, q = lane >> 4;
    const GAS bf16x8* ap = (const GAS bf16x8*)(A + (size_t)r * lda + 8 * q);
    const GAS bf16x8* bp[G];
#pragma unroll
    for (int g = 0; g < G; ++g) { bp[g] = (const GAS bf16x8*)(B.p[g] + (size_t)r * K + 8 * q); acc[g] = (f32x4){0.f, 0.f, 0.f, 0.f}; }
    const int nch = K / 256;
    bf16x8 a0[8], b0[G][8], a1[8], b1[G][8];
#pragma unroll
    for (int j = 0; j < 8; ++j) { a0[j] = ap[4 * j];
#pragma unroll
        for (int g = 0; g < G; ++g) b0[g][j] = bp[g][4 * j]; }
    for (int c = 0; c < nch; c += 2) {
        if (c + 1 < nch) {
#pragma unroll
            for (int j = 0; j < 8; ++j) { a1[j] = ap[32 * (c + 1) + 4 * j];
#pragma unroll
                for (int g = 0; g < G; ++g) b1[g][j] = bp[g][32 * (c + 1) + 4 * j]; } }
        __builtin_amdgcn_sched_barrier(0);
#pragma unroll
        for (int j = 0; j < 8; ++j)
#pragma unroll
            for (int g = 0; g < G; ++g) acc[g] = __builtin_amdgcn_mfma_f32_16x16x32_bf16(b0[g][j], a0[j], acc[g], 0, 0, 0);
        __builtin_amdgcn_sched_barrier(0);
        if (c + 1 < nch) {
            if (c + 2 < nch) {
#pragma unroll
                for (int j = 0; j < 8; ++j) { a0[j] = ap[32 * (c + 2) + 4 * j];
#pragma unroll
                    for (int g = 0; g < G; ++g) b0[g][j] = bp[g][32 * (c + 2) + 4 * j]; } }
            __builtin_amdgcn_sched_barrier(0);
#pragma unroll
            for (int j = 0; j < 8; ++j)
#pragma unroll
                for (int g = 0; g < G; ++g) acc[g] = __builtin_amdgcn_mfma_f32_16x16x32_bf16(b1[g][j], a1[j], acc[g], 0, 0, 0);
            __builtin_amdgcn_sched_barrier(0);
        }
    }
}
__device__ __forceinline__ v2u pack4(const f32x4 v) { v2u w; w.x = pk2(v[0], v[1]); w.y = pk2(v[2], v[3]); return w; }

namespace att {
constexpr int L_K = 0, L_V = 32768, L_WS = 65536, L_OST = L_WS + NWAVES * 256, L_BT = L_OST + NWAVES * 4096, L_END = L_BT + 16 * 128 * 4;
static_assert(L_END <= RING_BYTES, "attention LDS");
#define SBAR() __builtin_amdgcn_sched_barrier(0)
__device__ __forceinline__ int crow(int r, int hi) { return (r & 3) + 8 * (r >> 2) + 4 * hi; }
__device__ __forceinline__ void glds16(const void* gsrc, unsigned lds_dst) { unsigned keep;
    asm volatile("s_mov_b32 %0, m0\n\ts_mov_b32 m0, %2\n\ts_nop 0\n\tglobal_load_lds_dwordx4 %1, off\n\ts_mov_b32 m0, %0" : "=&s"(keep) : "v"(gsrc), "s"(lds_dst) : "memory"); }
typedef float f32x2_t __attribute__((ext_vector_type(2))); typedef __bf16 bf16x2_t __attribute__((ext_vector_type(2)));
__device__ __forceinline__ unsigned cvtpk_s(float lo, float hi) { f32x2_t v = {lo, hi}; bf16x2_t b = __builtin_convertvector(v, bf16x2_t); return __builtin_bit_cast(unsigned, b); }

__device__ __forceinline__ int t5_bucket(int n) {
    if (n < 16) return n;
    int b = 16;
    b += (n >= 19); b += (n >= 21); b += (n >= 24); b += (n >= 27); b += (n >= 31); b += (n >= 35); b += (n >= 40); b += (n >= 46);
    b += (n >= 52); b += (n >= 59); b += (n >= 67); b += (n >= 77); b += (n >= 87); b += (n >= 99); b += (n >= 113);
    return b;
}
__device__ __forceinline__ void build_bias_table(LAS unsigned char* lds, const float* rel_bias, int tid) {
    LAS float* bt = (LAS float*)(lds + L_BT);
    for (int i = tid; i < 16 * 128; i += NWAVES * 64) { const int h = i >> 7, rel = i & 127; bt[i] = rel_bias[t5_bucket(rel) * 16 + h] * LOG2E; }
}

__device__ __forceinline__ void qkt(f32x16& p0, f32x16& p1, const LAS unsigned char* Kslot, const bf16x8* qr, int r32, int hi) {
    const LAS unsigned char* kb = Kslot + hi * 1024 + r32 * 16;
    const f32x16 z = {0.f, 0.f, 0.f, 0.f, 0.f, 0.f, 0.f, 0.f, 0.f, 0.f, 0.f, 0.f, 0.f, 0.f, 0.f, 0.f};
#pragma unroll
    for (int d0 = 0; d0 < 4; ++d0) {
        const bf16x8 b0 = *(const LAS bf16x8*)(kb + d0 * 2048);
        const bf16x8 b1 = *(const LAS bf16x8*)(kb + d0 * 2048 + 512);
        if (d0 == 0) { p0 = __builtin_amdgcn_mfma_f32_32x32x16_bf16(b0, qr[0], z, 0, 0, 0); p1 = __builtin_amdgcn_mfma_f32_32x32x16_bf16(b1, qr[0], z, 0, 0, 0); }
        else { p0 = __builtin_amdgcn_mfma_f32_32x32x16_bf16(b0, qr[d0], p0, 0, 0, 0); p1 = __builtin_amdgcn_mfma_f32_32x32x16_bf16(b1, qr[d0], p1, 0, 0, 0); }
    }
}
__device__ __forceinline__ void pv(f32x16* o, int vb, bf16x8 pa0, bf16x8 pa1, bf16x8 pa2, bf16x8 pa3) {
#pragma unroll
    for (int d0 = 0; d0 < 2; ++d0) { s16x4 lo[4], hi[4];
#pragma unroll
        for (int ks = 0; ks < 4; ++ks) {
            asm volatile("ds_read_b64_tr_b16 %0,%1 offset:%c2" : "=&v"(lo[ks]) : "v"(vb), "i"(d0 * 4096 + ks * 1024) : "memory");
            asm volatile("ds_read_b64_tr_b16 %0,%1 offset:%c2" : "=&v"(hi[ks]) : "v"(vb), "i"(d0 * 4096 + ks * 1024 + 512) : "memory"); }
        asm volatile("s_waitcnt lgkmcnt(0)" ::: "memory"); SBAR();
#define PK(k) (bf16x8){lo[k][0], lo[k][1], lo[k][2], lo[k][3], hi[k][0], hi[k][1], hi[k][2], hi[k][3]}
        o[d0] = __builtin_amdgcn_mfma_f32_32x32x16_bf16(pa0, PK(0), o[d0], 0, 0, 0);
        o[d0] = __builtin_amdgcn_mfma_f32_32x32x16_bf16(pa1, PK(1), o[d0], 0, 0, 0);
        o[d0] = __builtin_amdgcn_mfma_f32_32x32x16_bf16(pa2, PK(2), o[d0], 0, 0, 0);
        o[d0] = __builtin_amdgcn_mfma_f32_32x32x16_bf16(pa3, PK(3), o[d0], 0, 0, 0);
#undef PK
    }
}

__device__ __forceinline__ void attn_kv_unit(LAS unsigned char* lds, int b, int blk, int kvh, bf16* Q, const bf16* KB, const bf16* VB, const float* sinks_l, const int wave_s) {
    const int tid = opq_tid(), lane = tid & 63, r32 = lane & 31, hi = lane >> 5; const int wid = __builtin_amdgcn_readfirstlane(tid >> 6);
    const unsigned lds0 = (unsigned)(uintptr_t)lds;
    const long rowq = (long)b * SEQ + 128 * blk;
#pragma unroll
    for (int t4 = 0; t4 < 4; ++t4) {
        const long grow = (blk == 0 && t4 < 2) ? ((long)b * SEQ + 64 * t4) : (rowq - 128 + 64 * t4);
        glds16(KB + (grow + lane) * NKV + kvh * 64 + wid * 8, (unsigned)__builtin_amdgcn_readfirstlane(lds0 + L_K + t4 * 8192 + wid * 1024));
        glds16(VB + (grow + 16 * (wid & 3) + (lane >> 2)) * NKV + kvh * 64 + (wid >> 2) * 32 + (lane & 3) * 8, (unsigned)__builtin_amdgcn_readfirstlane(lds0 + L_V + t4 * 8192 + wid * 1024));
    }
    asm volatile("s_waitcnt vmcnt(0)" ::: "memory"); __syncthreads();
    LAS float* wsf = (LAS float*)(lds + L_WS) + wid * 64;
    const int wq = wid & 3, t0 = wq >> 1, qi = 32 * wq + r32;
#pragma unroll 1
    for (int hp = 0; hp < 2; ++hp) {
        const int h = 4 * kvh + 2 * hp + (wid >> 2);
        bf16* Qw = Q + (rowq + 32 * wq) * DM + h * 64;
        bf16x8 qr[4];
#pragma unroll
        for (int d0 = 0; d0 < 4; ++d0) qr[d0] = *(const GAS bf16x8*)(Qw + (long)r32 * DM + d0 * 16 + hi * 8);
        f32x16 p[3][2];
#pragma unroll
        for (int tt = 0; tt < 3; ++tt) qkt(p[tt][0], p[tt][1], lds + L_K + (t0 + tt) * 8192, qr, r32, hi);
        const LAS float* bt = (const LAS float*)(lds + L_BT) + h * 128;
        const float sink2 = sinks_l[h] * LOG2E;
        float mx = sink2;
        int qi_ = qi; asm volatile("" : "+v"(qi_));
        const unsigned lim = (blk > 0) ? 128u : (unsigned)(qi_ + 1);
#pragma unroll
        for (int tt = 0; tt < 3; ++tt)
#pragma unroll
            for (int hf = 0; hf < 2; ++hf)
#pragma unroll
                for (int r = 0; r < 16; ++r) { const int kj = 64 * (t0 + tt) + 32 * hf + crow(r, hi); const int rel = qi_ + 128 - kj;
                    const bool valid = (unsigned)rel < lim;
                    const float bv = bt[rel];
                    const float s = valid ? p[tt][hf][r] + bv : -1e30f; p[tt][hf][r] = s; mx = fmaxf(mx, s); if (r == 15) SBAR(); }
        { auto rr = __builtin_amdgcn_permlane32_swap(__float_as_uint(mx), __float_as_uint(mx), false, false); mx = fmaxf(__uint_as_float(rr[0]), __uint_as_float(rr[1])); }
        float lsum = 0.f;
#pragma unroll
        for (int tt = 0; tt < 3; ++tt)
#pragma unroll
            for (int hf = 0; hf < 2; ++hf)
#pragma unroll
                for (int r = 0; r < 16; ++r) { const float e = __builtin_amdgcn_exp2f(p[tt][hf][r] - mx); p[tt][hf][r] = e; lsum += e; }
        { auto rr = __builtin_amdgcn_permlane32_swap(__float_as_uint(lsum), __float_as_uint(lsum), false, false); lsum = __uint_as_float(rr[0]) + __uint_as_float(rr[1]); }
        lsum += __builtin_amdgcn_exp2f(sink2 - mx);
        f32x16 o[2]; o[0] = f32x16{}; o[1] = f32x16{};
        const int vb0 = (int)(lds0 + L_V) + ((lane >> 4) & 1) * 32 + (lane & 3) * 8 + (4 * hi + ((lane & 15) >> 2)) * 64;
#pragma unroll
        for (int tt = 0; tt < 3; ++tt) {
            v4u pw0, pw1, pw2, pw3;
#define PKW(P, B) cvtpk_s(P[B], P[B + 1])
            pw0 = (v4u){PKW(p[tt][0], 0), PKW(p[tt][0], 2), PKW(p[tt][0], 4), PKW(p[tt][0], 6)}; pw1 = (v4u){PKW(p[tt][0], 8), PKW(p[tt][0], 10), PKW(p[tt][0], 12), PKW(p[tt][0], 14)};
            pw2 = (v4u){PKW(p[tt][1], 0), PKW(p[tt][1], 2), PKW(p[tt][1], 4), PKW(p[tt][1], 6)}; pw3 = (v4u){PKW(p[tt][1], 8), PKW(p[tt][1], 10), PKW(p[tt][1], 12), PKW(p[tt][1], 14)};
#undef PKW
            SBAR();
            pv(o, vb0 + (t0 + tt) * 8192, __builtin_bit_cast(bf16x8, pw0), __builtin_bit_cast(bf16x8, pw1), __builtin_bit_cast(bf16x8, pw2), __builtin_bit_cast(bf16x8, pw3));
        }
        if (hi == 0) wsf[32 + r32] = lsum;
        LDS_WAIT();
        float rli[16];
#pragma unroll
        for (int r = 0; r < 16; ++r) rli[r] = __builtin_amdgcn_rcpf(wsf[32 + crow(r, hi)]);
        LAS bf16* stg = (LAS bf16*)(lds + L_OST) + wid * 2048;
#pragma unroll
        for (int r = 0; r < 16; ++r) { const int orow = crow(r, hi);
#pragma unroll
            for (int d0 = 0; d0 < 2; ++d0) stg[orow * 64 + d0 * 32 + r32] = (bf16)f2bf(o[d0][r] * rli[r]); }
        LDS_WAIT();
#pragma unroll
        for (int i = 0; i < 4; ++i) { const int row = i * 8 + (lane >> 3), ch = lane & 7; const v4u v = *(const LAS v4u*)(stg + row * 64 + ch * 8); *(GAS v4u*)(Qw + (long)row * DM + ch * 8) = v; }
        LDS_WAIT();
    }
    __syncthreads();
}

__device__ __forceinline__ void conv_item(int it, const bf16* U, bf16* CB, const float* cw  , int lane) {
    const int row0 = (it >> 1) * 16, c0 = (it & 1) * 512 + lane * 8;
    float w0[8], w1[8], w2[8], um2[8], um1[8];
#pragma unroll
    for (int e = 0; e < 8; ++e) { w0[e] = cw[c0 + e]; w1[e] = cw[DM + c0 + e]; w2[e] = cw[2 * DM + c0 + e]; um2[e] = 0.f; um1[e] = 0.f; }
    if ((row0 & (SEQ - 1)) != 0) {
        const v4u a = *(const GAS v4u*)(U + (size_t)(row0 - 2) * DM + c0), b = *(const GAS v4u*)(U + (size_t)(row0 - 1) * DM + c0);
        um2[0] = bflo(a.x); um2[1] = bfhi(a.x); um2[2] = bflo(a.y); um2[3] = bfhi(a.y); um2[4] = bflo(a.z); um2[5] = bfhi(a.z); um2[6] = bflo(a.w); um2[7] = bfhi(a.w);
        um1[0] = bflo(b.x); um1[1] = bfhi(b.x); um1[2] = bflo(b.y); um1[3] = bfhi(b.y); um1[4] = bflo(b.z); um1[5] = bfhi(b.z); um1[6] = bflo(b.w); um1[7] = bfhi(b.w);
    }
#pragma unroll 4
    for (int i = 0; i < 16; ++i) {
        const size_t off = (size_t)(row0 + i) * DM + c0;
        const v4u uu = *(const GAS v4u*)(U + off), cc = *(const GAS v4u*)(CB + off);
        float u[8], cb[8], a[8];
        u[0] = bflo(uu.x); u[1] = bfhi(uu.x); u[2] = bflo(uu.y); u[3] = bfhi(uu.y); u[4] = bflo(uu.z); u[5] = bfhi(uu.z); u[6] = bflo(uu.w); u[7] = bfhi(uu.w);
        cb[0] = bflo(cc.x); cb[1] = bfhi(cc.x); cb[2] = bflo(cc.y); cb[3] = bfhi(cc.y); cb[4] = bflo(cc.z); cb[5] = bfhi(cc.z); cb[6] = bflo(cc.w); cb[7] = bfhi(cc.w);
#pragma unroll
        for (int e = 0; e < 8; ++e) { a[e] = cb[e] * (w0[e] * um2[e] + w1[e] * um1[e] + w2[e] * u[e]); um2[e] = um1[e]; um1[e] = u[e]; }
        v4u o; o.x = pk2(a[0], a[1]); o.y = pk2(a[2], a[3]); o.z = pk2(a[4], a[5]); o.w = pk2(a[6], a[7]);
        *(GAS v4u*)(CB + off) = o;
    }
}

__device__ __forceinline__ void sample_attn_task(int db, int kvh, int l, LAS float* scr, const LAS float* btab, bf16* Q, const bf16* KB, const bf16* VB,
                                                 const float* cache_k, const float* cache_v, float* out_k, float* out_v, const float* sinks_l, int lane) {
    const int kq = lane >> 4, ch = lane & 15;
    float q[4][4];
#pragma unroll
    for (int g = 0; g < 4; ++g) { const v2u w = *(const GAS v2u*)(Q + (size_t)(MP + db) * DM + (4 * kvh + g) * 64 + 4 * ch); q[g][0] = bflo(w.x); q[g][1] = bfhi(w.x); q[g][2] = bflo(w.y); q[g][3] = bfhi(w.y); }
    const size_t cbase = ((size_t)(l * MS + db) * 128 * 4 + kvh) * 64;
    const float* ck = cache_k + cbase; const float* cv = cache_v + cbase; float* ok = out_k + cbase; float* ov = out_v + cbase;
#pragma unroll 4
    for (int it = 0; it < 32; ++it) { const int key = 4 * it + kq;
        const f32x4 kv = *(const GAS f32x4*)(ck + (size_t)key * 256 + 4 * ch);
        if (key >= 1) *(GAS f32x4*)(ok + (size_t)(key - 1) * 256 + 4 * ch) = kv;
#pragma unroll
        for (int g = 0; g < 4; ++g) { float pg = (q[g][0] * kv[0] + q[g][1] * kv[1]) + (q[g][2] * kv[2] + q[g][3] * kv[3]);
            pg += __shfl_xor(pg, 1); pg += __shfl_xor(pg, 2); pg += __shfl_xor(pg, 4); pg += __shfl_xor(pg, 8);
            if (ch == 0) scr[g * 132 + key] = pg; } }
    float sn[4];
    { const v2u w = *(const GAS v2u*)(KB + (size_t)(MP + db) * NKV + kvh * 64 + 4 * ch); const float k0 = bflo(w.x), k1 = bfhi(w.x), k2 = bflo(w.y), k3 = bfhi(w.y);
#pragma unroll
      for (int g = 0; g < 4; ++g) { float pg = (q[g][0] * k0 + q[g][1] * k1) + (q[g][2] * k2 + q[g][3] * k3);
          pg += __shfl_xor(pg, 1); pg += __shfl_xor(pg, 2); pg += __shfl_xor(pg, 4); pg += __shfl_xor(pg, 8); sn[g] = pg; } }
    LDS_WAIT();
    float pnew[4], rden[4];
#pragma unroll
    for (int g = 0; g < 4; ++g) { const int h = 4 * kvh + g; const float sink2 = sinks_l[h] * LOG2E;
        const int j0 = lane, j1 = lane + 64;
        const float s0 = (j0 >= 1) ? scr[g * 132 + j0] + btab[h * 128 + (128 - j0) - (j0 == 0)] : -1e30f;
        const float s1 = scr[g * 132 + j1] + btab[h * 128 + 128 - j1];
        const float snew = sn[g] + btab[h * 128];
        const float m = fmaxf(fmaxf(wave_max(fmaxf(s0, s1)), snew), sink2);
        const float p0 = __builtin_amdgcn_exp2f(s0 - m), p1 = __builtin_amdgcn_exp2f(s1 - m); pnew[g] = __builtin_amdgcn_exp2f(snew - m);
        rden[g] = 1.0f / (wave_sum(p0 + p1) + pnew[g] + __builtin_amdgcn_exp2f(sink2 - m));
        scr[g * 132 + j0] = p0; scr[g * 132 + j1] = p1; }
    LDS_WAIT();
    float o[4][4];
#pragma unroll
    for (int g = 0; g < 4; ++g)
#pragma unroll
        for (int e = 0; e < 4; ++e) o[g][e] = 0.f;
#pragma unroll 4
    for (int it = 0; it < 32; ++it) { const int key = 4 * it + kq;
        const f32x4 vv = *(const GAS f32x4*)(cv + (size_t)key * 256 + 4 * ch);
        if (key >= 1) *(GAS f32x4*)(ov + (size_t)(key - 1) * 256 + 4 * ch) = vv;
#pragma unroll
        for (int g = 0; g < 4; ++g) { const float pk = scr[g * 132 + key];
#pragma unroll
            for (int e = 0; e < 4; ++e) o[g][e] += pk * vv[e]; } }
    const v2u wv = *(const GAS v2u*)(VB + (size_t)(MP + db) * NKV + kvh * 64 + 4 * ch); const float vn[4] = {bflo(wv.x), bfhi(wv.x), bflo(wv.y), bfhi(wv.y)};
#pragma unroll
    for (int g = 0; g < 4; ++g) { f32x4 r;
#pragma unroll
        for (int e = 0; e < 4; ++e) { float v = o[g][e]; v += __shfl_xor(v, 16); v += __shfl_xor(v, 32); r[e] = (v + pnew[g] * vn[e]) * rden[g]; }
        if (kq == 0) *(GAS v2u*)(Q + (size_t)(MP + db) * DM + (4 * kvh + g) * 64 + 4 * ch) = pack4(r); }
    LDS_WAIT();
}
#undef SBAR
}

constexpr int PH_PER_LAYER = 11, NPHASE = 1 + NLAYER * PH_PER_LAYER;
enum { K_GU1 = 0, K_DN1, K_ROW1, K_WIN, K_MIX, K_GATE, K_WOUT, K_ROW2, K_GU2, K_DN2, K_ROW3 };

#define SM_LANE_SETUP() const int lane = opq_lane(), wave = wave_s; const int srow = 16 * wave + (lane & 15), sq = lane >> 4; (void)srow; (void)sq
#define SM_FOR_ITEMS(nitems) for (int it = (int)(((unsigned)bid + 128u) & 255u); it < (nitems); it += 256)

__global__ void __launch_bounds__(NWAVES * 64, 2) mk_fwd(Args args) {
    extern __shared__ __attribute__((aligned(16))) unsigned char lds_raw[];
    LAS unsigned char* const ldsb = (LAS unsigned char*)lds_raw;
    for (int u = threadIdx.x; u < (LDS_BYTES - LDSCTL_OFF) / 4; u += NWAVES * 64) ((LAS unsigned*)(ldsb + LDSCTL_OFF))[u] = 0u;
    __syncthreads();
#if !MK_LAUNCH_PER_PHASE
    XcdBarrier bar = xcd_barrier_post((unsigned*)(args.ws + WS_CTL) + CW_BAR, (volatile LAS unsigned*)(ldsb + MISC_OFF) + 8);
#define GRID_BAR() xcd_barrier(bar)
#else
#define GRID_BAR() do {} while (0)
#endif
    const int lo = args.ph_lo, hi = args.ph_hi;
    const int wave_s = __builtin_amdgcn_readfirstlane(threadIdx.x >> 6);
    for (int ph = lo; ph < hi; ++ph) {
        unsigned long long z; asm volatile("s_mov_b64 %0, 0" : "=s"(z));
        Frame F;
        F.lds = ldsb;
        F.wave = wave_s;
        const int bid = opq_bid();
        F.G = gridDim.x; { const int bx = bid; F.vcu = (F.G % 8 == 0) ? (bx % 8) * (F.G / 8) + bx / 8 : bx; }
        F.ap = (const __attribute__((address_space(4))) Args*)((const __attribute__((address_space(4))) unsigned char*)__builtin_amdgcn_kernarg_segment_ptr() + z);
        unsigned char* const ws = F.ap->ws;
        bf16* const H = (bf16*)(ws + WS_H); bf16* const U = (bf16*)(ws + WS_U); bf16* const CB = (bf16*)(ws + WS_CB); bf16* const Qb = (bf16*)(ws + WS_Q);
        bf16* const SGA = (bf16*)(ws + WS_SGA); bf16* const SGB = (bf16*)(ws + WS_SGB); bf16* const KBb = (bf16*)(ws + WS_KB); bf16* const VBb = (bf16*)(ws + WS_VB);
        bf16* const ACT = (bf16*)(ws + WS_ACT); float* const DF = (float*)(ws + WS_DF); float* const DX = (float*)(ws + WS_DX);
        if (ph == 0) { p0_prologue(F); }
        else {
            const int l = (ph - 1) / PH_PER_LAYER, kind = (ph - 1) % PH_PER_LAYER;
            const unsigned char* wl = ws + WS_W + (size_t)l * W_LAYER;
            const float* ng = F.ap->in[I_NG] + (size_t)l * 6 * DM;
            if (kind == K_GU1 || kind == K_GU2) {
                const bf16* Wt = (const bf16*)(wl + (kind == K_GU1 ? WO_GU1 : WO_GU2));
                { pg8::Gemm g{H, Wt, MP, NGU, DM}; pg8::StaticOrder S; S.init(MP, NGU, F.G, bid);
                  pg8::EpiSwiGLU E{ACT, DFF};
                  pg8::gemm_phase<pg8::EpiSwiGLU, pg8::StaticOrder, PG8_ALIGN, PG8_SP2>(F.lds + RING_OFF, g, S, E, wave_s); }
                SM_LANE_SETUP();
                SM_FOR_ITEMS(DFF / 16) {
                    const int pn = it >> 3, sub = it & 7;
                    f32x4 ac[2]; sm_gemm<2>(H + (size_t)(MP + 16 * wave) * DM, DM, SmB<2>{{Wt + (size_t)(256 * pn + 16 * sub) * DM, Wt + (size_t)(256 * pn + 128 + 16 * sub) * DM}}, DM, lane, ac);
                    f32x4 o;
#pragma unroll
                    for (int e = 0; e < 4; ++e) o[e] = ac[0][e] * pg8::sigmoid_f(ac[0][e]) * ac[1][e];
                    *(GAS v2u*)(ACT + (size_t)(MP + srow) * DFF + 128 * pn + 16 * sub + 4 * sq) = pack4(o);
                }
            } else if (kind == K_DN1 || kind == K_DN2) {
                const bf16* Wt = (const bf16*)(wl + (kind == K_DN1 ? WO_D1 : WO_D2));
                { pg8::Gemm g{ACT, Wt, MP, DM, DFF}; pg8::StaticOrder S; S.init(MP, DM, F.G, bid);
                  pg8::EpiF32 E{DF, DM};
                  pg8::gemm_phase<pg8::EpiF32, pg8::StaticOrder, PG8_ALIGN, PG8_SP2>(F.lds + RING_OFF, g, S, E, wave_s); }
                SM_LANE_SETUP();
                SM_FOR_ITEMS(DM / 16) {
                    f32x4 ac[1]; sm_gemm<1>(ACT + (size_t)(MP + 16 * wave) * DFF, DFF, SmB<1>{{Wt + (size_t)(16 * it) * DFF}}, DFF, lane, ac);
                    *(GAS f32x4*)(DF + (size_t)(MP + srow) * DM + 16 * it + 4 * sq) = ac[0];
                }
            } else if (kind == K_ROW1 || kind == K_ROW2 || kind == K_ROW3) {
                const bool first = (l == 0 && kind == K_ROW1);
                const float* bp = first ? F.ap->in[I_XP] : F.ap->out + O_YP; const float* bs = first ? F.ap->in[I_XS] : F.ap->out + O_YS;
                if (kind == K_ROW1) row_phase(F, DF, bp, bs, ng + 1 * DM, ng + 2 * DM, 0.5f);
                else if (kind == K_ROW2) row_phase(F, DX, bp, bs, ng + 3 * DM, ng + 4 * DM, 1.0f);
                else row_phase(F, DF, bp, bs, ng + 5 * DM, (l + 1 < NLAYER) ? ng + 6 * DM : nullptr, 0.5f);
            } else if (kind == K_WIN) {
                const bf16* Wt = (const bf16*)(wl + WO_IN);
                float* stp = F.ap->out + O_STP + (size_t)l * NBATCH * 2 * DM; float* kwp = F.ap->out + O_KWP + (size_t)l * NBATCH * 128 * NKV; float* vwp = F.ap->out + O_VWP + (size_t)l * NBATCH * 128 * NKV;
                { pg8::Gemm g{H, Wt, MP, NIN, DM}; pg8::StaticOrder S; S.init(MP, NIN, F.G, bid);
                  pg8::EpiWin E{U, CB, Qb, SGA, SGB, KBb, VBb, stp, kwp, vwp, QSCALE};
                  pg8::gemm_phase<pg8::EpiWin, pg8::StaticOrder, PG8_ALIGN, PG8_SP2>(F.lds + RING_OFF, g, S, E, wave_s); }
                float* sts = F.ap->out + O_STS + (size_t)l * MS * 2 * DM; float* kws = F.ap->out + O_KWS + (size_t)l * MS * 128 * NKV; float* vws = F.ap->out + O_VWS + (size_t)l * MS * 128 * NKV;
                SM_LANE_SETUP();
                const bf16* As = H + (size_t)(MP + 16 * wave) * DM;
                SM_FOR_ITEMS(64 + 18 * 16) {
                    if (it < 64) {
                        const int pn = it >> 3, sub = it & 7;
                        f32x4 ac[2]; sm_gemm<2>(As, DM, SmB<2>{{Wt + (size_t)(256 * pn + 16 * sub) * DM, Wt + (size_t)(256 * pn + 128 + 16 * sub) * DM}}, DM, lane, ac);
                        const f32x4 o = ac[0] * ac[1]; const int col = 128 * pn + 16 * sub + 4 * sq;
                        *(GAS v2u*)(U + (size_t)(MP + srow) * DM + col) = pack4(o);
                        *(GAS f32x4*)(sts + (size_t)(srow * 2 + 1) * DM + col) = o;
                    } else {
                        const int j = it - 64, pn = 8 + (j >> 4), sub = j & 15;
                        f32x4 ac[1]; sm_gemm<1>(As, DM, SmB<1>{{Wt + (size_t)(256 * pn + 16 * sub) * DM}}, DM, lane, ac); f32x4 a0 = ac[0];
                        const int c = 16 * sub + 4 * sq;
                        if (pn < 12) *(GAS v2u*)(CB + (size_t)(MP + srow) * DM + 256 * (pn - 8) + c) = pack4(a0);
                        else if (pn < 16) *(GAS v2u*)(Qb + (size_t)(MP + srow) * DM + 256 * (pn - 12) + c) = pack4(a0 * QSCALE);
                        else if (pn == 16) { *(GAS v2u*)(KBb + (size_t)(MP + srow) * NKV + c) = pack4(a0); *(GAS f32x4*)(kws + ((size_t)srow * 128 + 127) * NKV + c) = a0; }
                        else if (pn == 17) { *(GAS v2u*)(VBb + (size_t)(MP + srow) * NKV + c) = pack4(a0); *(GAS f32x4*)(vws + ((size_t)srow * 128 + 127) * NKV + c) = a0; }
                        else {
#pragma unroll
                            for (int e = 0; e < 4; ++e) a0[e] = pg8::sigmoid_f(a0[e]);
                            if (pn < 22) *(GAS v2u*)(SGA + (size_t)(MP + srow) * DM + 256 * (pn - 18) + c) = pack4(a0);
                            else *(GAS v2u*)(SGB + (size_t)(MP + srow) * DM + 256 * (pn - 22) + c) = pack4(a0);
                        }
                    }
                }
            } else if (kind == K_MIX) {
                att::build_bias_table(F.lds, F.ap->in[I_RB], opq_tid());
                __syncthreads();
                const float* sinks_l = F.ap->in[I_SINK] + l * 16;
                for (int i = 0; i < 2; ++i) {
                    const int x = F.vcu >> 5, j = F.vcu & 31; const int gblk = 16 * x + (j >> 1), kvh = 2 * (j & 1) + i;
                    att::attn_kv_unit(F.lds, gblk >> 6, gblk & 63, kvh, Qb, KBb, VBb, sinks_l, wave_s);
                }
                SM_LANE_SETUP();
                att::conv_item(F.vcu * NWAVES + wave, U, CB, F.ap->in[I_CW] + (size_t)l * 3 * DM, lane);
                if (wave < 2) {
                    const int task = bid + 256 * wave;
                    att::sample_attn_task(task >> 2, task & 3, l, (LAS float*)(F.lds + att::L_OST) + wave * 1024, (const LAS float*)(F.lds + att::L_BT), Qb, KBb, VBb,
                                          F.ap->in[I_CK], F.ap->in[I_CV], F.ap->out + O_KWS, F.ap->out + O_VWS, sinks_l, lane);
                } else if (wave == 2 && bid < MS) {
                    const int db = bid; const float* cw = F.ap->in[I_CW] + (size_t)l * 3 * DM; const float* st = F.ap->in[I_STC] + (size_t)(l * MS + db) * 2 * DM;
                    float* sts = F.ap->out + O_STS + (size_t)(l * MS + db) * 2 * DM;
#pragma unroll
                    for (int hseg = 0; hseg < 2; ++hseg) { const int c0 = lane * 16 + hseg * 8;
                        const size_t off = (size_t)(MP + db) * DM + c0; const v4u uu = *(const GAS v4u*)(U + off), cc = *(const GAS v4u*)(CB + off);
                        const float u[8] = {bflo(uu.x), bfhi(uu.x), bflo(uu.y), bfhi(uu.y), bflo(uu.z), bfhi(uu.z), bflo(uu.w), bfhi(uu.w)};
                        const float cb[8] = {bflo(cc.x), bfhi(cc.x), bflo(cc.y), bfhi(cc.y), bflo(cc.z), bfhi(cc.z), bflo(cc.w), bfhi(cc.w)};
                        float a[8];
#pragma unroll
                        for (int e = 0; e < 8; ++e) { const int c = c0 + e; const float s0 = st[c], s1 = st[DM + c];
                            a[e] = cb[e] * (cw[c] * s0 + cw[DM + c] * s1 + cw[2 * DM + c] * u[e]); sts[c] = s1; }
                        v4u o; o.x = pk2(a[0], a[1]); o.y = pk2(a[2], a[3]); o.z = pk2(a[4], a[5]); o.w = pk2(a[6], a[7]);
                        *(GAS v4u*)(CB + off) = o; }
                }
            } else if (kind == K_GATE) {
                for (int pass = 0; pass < 2; ++pass) {
                    pg8::Gemm g{pass == 0 ? CB : Qb, (const bf16*)(wl + (pass == 0 ? WO_WC : WO_WA)), MP, DM, DM}; pg8::StaticOrder S; S.init(MP, DM, F.G, bid);
                    pg8::EpiGate E{pass == 0 ? SGA : SGB, U, pass == 0 ? U : SGA, pass};
                    pg8::gemm_phase<pg8::EpiGate, pg8::StaticOrder, PG8_ALIGN, PG8_SP2>(F.lds + RING_OFF, g, S, E, wave_s);
                }
                SM_LANE_SETUP();
                SM_FOR_ITEMS(DM / 16) {
                    f32x4 ac0[1], ac1[1];
                    sm_gemm<1>(CB + (size_t)(MP + 16 * wave) * DM, DM, SmB<1>{{(const bf16*)(wl + WO_WC) + (size_t)(16 * it) * DM}}, DM, lane, ac0);
                    sm_gemm<1>(Qb + (size_t)(MP + 16 * wave) * DM, DM, SmB<1>{{(const bf16*)(wl + WO_WA) + (size_t)(16 * it) * DM}}, DM, lane, ac1);
                    const f32x4 a0 = ac0[0], a1 = ac1[0];
                    const size_t off = (size_t)(MP + srow) * DM + 16 * it + 4 * sq;
                    const v2u ga = *(const GAS v2u*)(SGA + off), gb = *(const GAS v2u*)(SGB + off);
                    f32x4 o; o[0] = bflo(ga.x) * a0[0] + bflo(gb.x) * a1[0]; o[1] = bfhi(ga.x) * a0[1] + bfhi(gb.x) * a1[1]; o[2] = bflo(ga.y) * a0[2] + bflo(gb.y) * a1[2]; o[3] = bfhi(ga.y) * a0[3] + bfhi(gb.y) * a1[3];
                    *(GAS v2u*)(SGA + off) = pack4(o);
                }
            } else if (kind == K_WOUT) {
                const bf16* Wt = (const bf16*)(wl + WO_WO);
                { pg8::Gemm g{SGA, Wt, MP, DM, DM}; pg8::StaticOrder S; S.init(MP, DM, F.G, bid);
                  pg8::EpiF32 E{DX, DM};
                  pg8::gemm_phase<pg8::EpiF32, pg8::StaticOrder, PG8_ALIGN, PG8_SP2>(F.lds + RING_OFF, g, S, E, wave_s); }
                SM_LANE_SETUP();
                SM_FOR_ITEMS(DM / 16) {
                    f32x4 ac[1]; sm_gemm<1>(SGA + (size_t)(MP + 16 * wave) * DM, DM, SmB<1>{{Wt + (size_t)(16 * it) * DM}}, DM, lane, ac);
                    *(GAS f32x4*)(DX + (size_t)(MP + srow) * DM + 16 * it + 4 * sq) = ac[0];
                }
            }
        }
        if (ph + 1 < hi) GRID_BAR();
    }
}

extern "C" void kernel_launch(void* const* d_in, const int* in_sizes, int n_in, void* d_out, int out_size, void* d_ws, size_t ws_size, hipStream_t stream) {
    static int grid = 0;
    if (grid == 0) {
        if (n_in != 17 || in_sizes[0] != MP * DM || out_size != (int)O_END || ws_size < WS_END) {
            fprintf(stderr, "kernel_launch: unexpected problem: n_in %d in0 %d out %d ws %zu (need %zu)\n", n_in, n_in > 0 ? in_sizes[0] : -1, out_size, ws_size, (size_t)WS_END);
            grid = -1;
        } else {
            int dev = 0, cus = 0;
            if (hipGetDevice(&dev) != hipSuccess || hipDeviceGetAttribute(&cus, hipDeviceAttributeMultiprocessorCount, dev) != hipSuccess) { grid = -1; }
            else if (hipFuncSetAttribute((const void*)mk_fwd, hipFuncAttributeMaxDynamicSharedMemorySize, LDS_BYTES) != hipSuccess) { grid = -1; }
            else { (void)hipGetLastError(); grid = cus; if (grid != 256) fprintf(stderr, "kernel_launch: %d CUs (built for 256)\n", grid); }
        }
    }
    if (grid < 0) { (void)hipMemsetAsync(d_out, 0, (size_t)out_size * 4, stream); return; }
    (void)hipMemsetAsync((char*)d_ws + WS_CTL, 0, CTL_ZERO_BYTES, stream);
    Args a{};
    for (int i = 0; i < 17; ++i) a.in[i] = (const float*)d_in[i];
    a.out = (float*)d_out; a.ws = (unsigned char*)d_ws;
#if MK_LAUNCH_PER_PHASE
    for (int ph = 0; ph < NPHASE; ++ph) { a.ph_lo = ph; a.ph_hi = ph + 1; a.li = ph; hipLaunchKernelGGL(mk_fwd, dim3(grid), dim3(NWAVES * 64), LDS_BYTES, stream, a); }
#else
    a.ph_lo = 0; a.ph_hi = NPHASE; a.li = 0;
    hipLaunchKernelGGL(mk_fwd, dim3(grid), dim3(NWAVES * 64), LDS_BYTES, stream, a);
#endif
}
```
